# Optimizing an MI355X kernel written in HIP

```python
import jax, jax.numpy as jnp
from jax import lax
import numpy as np


D_MODEL = 1024
BATCH = 8
SEQ = 4096
DEPTH = 1

CHUNK = 64
Q_BLOCK = 64
ROPE_THETA = 500000.0
EPS = 1e-6

A_HEADS = 8
A_HEAD_DIM = 64
A_WIDTH = A_HEADS * A_HEAD_DIM
IDX_HEADS = 16
IDX_DIM = 64
TOPK_MAX = 256

B_HEADS = 4
B_HEAD_DIM = 128
B_WIDTH = B_HEADS * B_HEAD_DIM
CONV_WIDTH = 4

IN_SIZES = (
    A_WIDTH, A_WIDTH, A_WIDTH, A_WIDTH,
    IDX_HEADS * IDX_DIM, IDX_DIM, IDX_HEADS,
    B_WIDTH, B_WIDTH, B_WIDTH, B_WIDTH, B_WIDTH,
    B_HEADS, B_HEADS,
    D_MODEL, D_MODEL,
)
N_IN = sum(IN_SIZES)

kernel_name = 'hybrid_dsa_mlstm_gated_merge'


def rmsnorm(x, g):
    x32 = x.astype(jnp.float32)
    y = x32 * lax.rsqrt(jnp.mean(x32 * x32, axis=-1, keepdims=True) + EPS)
    return (y * g.astype(jnp.float32)).astype(x.dtype)


def head_norm(x, g):
    shp = x.shape
    x32 = x.astype(jnp.float32).reshape(shp[:-1] + (B_HEADS, B_HEAD_DIM))
    mu = jnp.mean(x32, axis=-1, keepdims=True)
    var = jnp.mean(jnp.square(x32 - mu), axis=-1, keepdims=True)
    y = ((x32 - mu) * lax.rsqrt(var + EPS)).reshape(shp)
    return (y * g.astype(jnp.float32)).astype(x.dtype)


def partial_rope(x, pos):
    d = x.shape[-1]
    rd = d // 4
    half = rd // 2
    inv = ROPE_THETA ** (-(jnp.arange(half, dtype=jnp.float32) * 2.0 / rd))
    ang = pos.astype(jnp.float32)[:, None] * inv[None, :]
    cos = jnp.cos(ang)[:, None, :]
    sin = jnp.sin(ang)[:, None, :]
    x32 = x.astype(jnp.float32)
    x1, x2, rest = x32[..., :half], x32[..., half:rd], x32[..., rd:]
    out = jnp.concatenate([x1 * cos - x2 * sin, x1 * sin + x2 * cos, rest], axis=-1)
    return out.astype(x.dtype)


def causal_conv(u, w, b):
    K = w.shape[0]
    S = u.shape[1]
    up = jnp.pad(u, ((0, 0), (K - 1, 0), (0, 0)))
    return sum(up[:, j:j + S] * w[j] for j in range(K)) + b


def dsa_attention(q, k, v, qi, ki, wi, k_sel):
    Bsz, S, H, Dh = q.shape
    nblk = S // Q_BLOCK
    kchunk = jnp.arange(S) // CHUNK
    ki32 = ki.astype(jnp.float32)

    def blocks(a):
        return jnp.moveaxis(a.reshape((Bsz, nblk, Q_BLOCK) + a.shape[2:]), 1, 0)

    qpos = jnp.arange(S).reshape(nblk, Q_BLOCK)

    def one_block(args):
        q_b, qi_b, wi_b, pos_b = args
        s_idx = jnp.einsum('bthd,bsd->bths', qi_b.astype(jnp.float32), ki32) * (IDX_DIM ** -0.5)
        score = jnp.einsum('bth,bths->bts', wi_b.astype(jnp.float32), jax.nn.relu(s_idx))
        qchunk = pos_b // CHUNK
        admissible = kchunk[None, :] <= qchunk[:, None]
        score = jnp.where(admissible[None], score, -jnp.inf)
        _, idx = lax.top_k(score, k_sel)
        valid = (idx // CHUNK) <= qchunk[None, :, None]
        k_g = jax.vmap(lambda kb, ib: kb[ib])(k, idx)
        v_g = jax.vmap(lambda vb, ib: vb[ib])(v, idx)
        logits = jnp.einsum('bthd,btjhd->bthj', q_b.astype(jnp.float32),
                            k_g.astype(jnp.float32)) * (Dh ** -0.5)
        logits = jnp.where(valid[:, :, None, :], logits, -jnp.inf)
        p = jax.nn.softmax(logits, axis=-1)
        out = jnp.einsum('bthj,btjhd->bthd', p, v_g.astype(jnp.float32))
        return out.astype(q.dtype)

    out = lax.map(one_block, (blocks(q), blocks(qi), blocks(wi), qpos))
    return jnp.moveaxis(out, 0, 1).reshape(Bsz, S, H * Dh)


def mlstm_chunkwise(q, k, v, log_i, log_f):
    Bsz, H, S, dk = q.shape
    dv = v.shape[-1]
    nc = S // CHUNK

    def to_chunks(a):
        a = a.astype(jnp.float32)
        return jnp.moveaxis(a.reshape((Bsz, H, nc, CHUNK) + a.shape[3:]), 2, 0)

    xs = (to_chunks(q), to_chunks(k), to_chunks(v), to_chunks(log_i), to_chunks(log_f))
    causal = jnp.tril(jnp.ones((CHUNK, CHUNK), dtype=bool))

    def step(carry, xc):
        C, n, m = carry
        qc, kc, vc, li, lf = xc
        b = jnp.cumsum(lf, axis=-1)
        D = jnp.where(causal, b[..., :, None] - b[..., None, :] + li[..., None, :], -jnp.inf)
        m_inter = b + m[..., None]
        m_t = jnp.maximum(m_inter, jnp.max(D, axis=-1))
        w_inter = jnp.exp(m_inter - m_t)
        P = jnp.exp(D - m_t[..., None])
        s_qk = jnp.einsum('bhtd,bhsd->bhts', qc, kc) * P
        num = (w_inter[..., None] * jnp.einsum('bhtd,bhde->bhte', qc, C)
               + jnp.einsum('bhts,bhse->bhte', s_qk, vc))
        den = w_inter * jnp.einsum('bhtd,bhd->bht', qc, n) + jnp.sum(s_qk, axis=-1)
        h = num / jnp.maximum(jnp.abs(den), jnp.exp(-m_t))[..., None]
        b_L = b[..., -1]
        g = b_L[..., None] - b + li
        m_new = jnp.maximum(b_L + m, jnp.max(g, axis=-1))
        decay = jnp.exp(b_L + m - m_new)
        wk = jnp.exp(g - m_new[..., None])
        C_new = decay[..., None, None] * C + jnp.einsum('bhs,bhsd,bhse->bhde', wk, kc, vc)
        n_new = decay[..., None] * n + jnp.einsum('bhs,bhsd->bhd', wk, kc)
        return (C_new, n_new, m_new), h

    init = (jnp.zeros((Bsz, H, dk, dv), jnp.float32),
            jnp.zeros((Bsz, H, dk), jnp.float32),
            jnp.zeros((Bsz, H), jnp.float32))
    _, hs = lax.scan(step, init, xs)
    return jnp.moveaxis(hs, 0, 2).reshape(Bsz, H, S, dv)


def setup_inputs(seed: int = 0) -> dict:
    key = jax.random.key(seed)
    ks = jax.random.split(key, 12)
    f32 = jnp.float32
    x = jax.random.normal(ks[0], (BATCH, SEQ, D_MODEL), f32)
    norm_g = 1.0 + 0.05 * jax.random.normal(ks[1], (DEPTH, D_MODEL), f32)
    w_in = jax.random.normal(ks[2], (DEPTH, D_MODEL, N_IN), f32) * D_MODEL ** -0.5
    conv_w = jax.random.normal(ks[3], (DEPTH, CONV_WIDTH, 2 * B_WIDTH), f32) * CONV_WIDTH ** -0.5
    conv_b = 0.02 * jax.random.normal(ks[4], (DEPTH, 2 * B_WIDTH), f32)
    b_igate = 0.1 * jax.random.normal(ks[5], (DEPTH, B_HEADS), f32)
    b_fgate = 3.0 + 3.0 * jax.random.uniform(ks[6], (DEPTH, B_HEADS), f32)
    head_norm_g = 1.0 + 0.05 * jax.random.normal(ks[7], (DEPTH, B_WIDTH), f32)
    w_branch_a = jax.random.normal(ks[8], (DEPTH, A_WIDTH, D_MODEL), f32) * A_WIDTH ** -0.5
    w_branch_b = jax.random.normal(ks[9], (DEPTH, B_WIDTH, D_MODEL), f32) * B_WIDTH ** -0.5
    w_out = jax.random.normal(ks[10], (DEPTH, D_MODEL, D_MODEL), f32) * D_MODEL ** -0.5
    final_norm_g = 1.0 + 0.05 * jax.random.normal(ks[11], (D_MODEL,), f32)
    return {'x': x, 'norm_g': norm_g, 'w_in': w_in, 'conv_w': conv_w, 'conv_b': conv_b,
            'b_igate': b_igate, 'b_fgate': b_fgate, 'head_norm_g': head_norm_g,
            'w_branch_a': w_branch_a, 'w_branch_b': w_branch_b, 'w_out': w_out,
            'final_norm_g': final_norm_g}


def reference(x, norm_g, w_in, conv_w, conv_b, b_igate, b_fgate, head_norm_g,
              w_branch_a, w_branch_b, w_out, final_norm_g):
    Bsz, S, _ = x.shape
    pos = jnp.arange(S)
    k_sel = min(TOPK_MAX, S // 4)
    offsets = np.cumsum(IN_SIZES)[:-1]
    for l in range(DEPTH):
        h = rmsnorm(x, norm_g[l])
        (a_q, a_k, a_v, a_z, i_q, i_k, i_w,
         b_q, b_k, b_v, b_z, b_o, b_i, b_f, g_a, g_b) = jnp.split(h @ w_in[l], offsets, axis=-1)

        q_a = partial_rope(a_q.reshape(Bsz, S, A_HEADS, A_HEAD_DIM), pos)
        k_a = partial_rope(a_k.reshape(Bsz, S, A_HEADS, A_HEAD_DIM), pos)
        v_a = a_v.reshape(Bsz, S, A_HEADS, A_HEAD_DIM)
        q_i = partial_rope(i_q.reshape(Bsz, S, IDX_HEADS, IDX_DIM), pos)
        k_i = partial_rope(i_k[:, :, None, :], pos)[:, :, 0]
        w_i = i_w * IDX_HEADS ** -0.5
        o_a = dsa_attention(q_a, k_a, v_a, q_i, k_i, w_i, k_sel)
        y_a = (o_a * jax.nn.silu(a_z)) @ w_branch_a[l]

        qk_b = jax.nn.silu(causal_conv(jnp.concatenate([b_q, b_k], axis=-1), conv_w[l], conv_b[l]))
        q_b, k_b = jnp.split(qk_b, 2, axis=-1)

        def heads(t):
            return t.reshape(Bsz, S, B_HEADS, B_HEAD_DIM).transpose(0, 2, 1, 3)

        log_i = (b_i + b_igate[l]).astype(jnp.float32).transpose(0, 2, 1)
        log_f = jax.nn.log_sigmoid((b_f + b_fgate[l]).astype(jnp.float32)).transpose(0, 2, 1)
        cell = mlstm_chunkwise(heads(q_b), heads(k_b) * B_HEAD_DIM ** -0.5, heads(b_v), log_i, log_f)
        cell = cell.transpose(0, 2, 1, 3).reshape(Bsz, S, B_WIDTH).astype(x.dtype)
        h_b = head_norm(jax.nn.sigmoid(b_o) * cell, head_norm_g[l])
        y_b = (h_b * jax.nn.silu(b_z)) @ w_branch_b[l]

        merged = jax.nn.sigmoid(g_a) * y_a + jax.nn.sigmoid(g_b) * y_b
        x = x + merged @ w_out[l]
    return rmsnorm(x, final_norm_g)
```

```cpp
#include <hip/hip_runtime.h>
#include <cstdio>
#include <cstdint>
namespace pg8 {
#define PG8_LAS __attribute__((address_space(3)))
typedef unsigned short bf16_t;
typedef short bf16x8 __attribute__((ext_vector_type(8)));
typedef float f32x4 __attribute__((ext_vector_type(4)));
typedef unsigned u32x4 __attribute__((ext_vector_type(4)));
typedef _Float16 hx8 __attribute__((ext_vector_type(8)));
constexpr int BM = 256, BK = 64, HALF = 128, HTB = HALF * BK * 2  , STAGE_BYTES = 8 * HTB, NXCD = 8, WGM = 8;

__host__ __device__ __forceinline__ int lds_byte(int r, int c) { const int st = (r >> 4) * 2 + (c >> 5), rr = r & 15, cc = c & 31, ob = rr * 64 + cc * 2; return st * 1024 + (ob ^ (((ob >> 9) & 1) << 5)); }
__host__ __device__ __forceinline__ void stage_rc(int b, int& R, int& C) { const int st = b / 1024, sb = b % 1024, swz = sb ^ (((sb >> 9) & 1) << 5); R = (st >> 1) * 16 + swz / 64; C = (st & 1) * 32 + (swz % 64) / 2; }
__host__ __device__ __forceinline__ int perm32(int rho) { const int n = rho >> 4, i = rho & 15; return 8 * (i >> 2) + 4 * n + (i & 3); }

struct Unit { int pm, pn; };
struct Gemm { const bf16_t* A; const bf16_t* Bt; int M, N, K; };

struct StaticOrder {
    int nM, nN, nwg, G, c;
    __host__ __device__ void init(int M, int N, int G_, int c_) { nM = M / BM; nN = N / BM; nwg = nM * nN; G = G_; c = c_; }
    __host__ __device__ bool next(int i, Unit& u) const {
        const long L = (long)i * G + c; if (L >= nwg) return false;
        int wgid = (int)L; { const int q = nwg / NXCD, r = nwg % NXCD, xcd = wgid % NXCD, off = wgid / NXCD; wgid = (xcd < r ? xcd * (q + 1) : r * (q + 1) + (xcd - r) * q) + off; }
        const int nig = WGM * nN, gid = wgid / nig, fm = gid * WGM, gsz = (nM - fm) < WGM ? (nM - fm) : WGM;
        u.pm = fm + ((wgid % nig) % gsz); u.pn = (wgid % nig) / gsz; return true;
    }
    __device__ __forceinline__ void a_ready(const Unit&) const {}
    __device__ __forceinline__ void done(const Unit&) const {}
};

template <class Epi, class Sched, bool ALIGN_EPI = false, bool SP2 = false>
__device__ __forceinline__ void gemm_phase(PG8_LAS unsigned char* lds, const Gemm g, const Sched& S, const Epi& E) {
    const int tid = threadIdx.x, wid = __builtin_amdgcn_readfirstlane(tid >> 6), lane = tid & 63, wr = wid >> 2, wc = wid & 3, fr = lane & 15, fq = lane >> 4;
    const int K = g.K, nt = K / BK;
    unsigned voffA[2], voffB[2];
#pragma unroll
    for (int i = 0; i < 2; ++i) { int R, C; stage_rc(tid * 16 + i * 8192, R, C); const int Rb = Epi::PERM ? ((R & ~31) + perm32(R & 31)) : R;
        voffA[i] = (unsigned)(R * K + C) * 2u; voffB[i] = (unsigned)(Rb * K + C) * 2u; }
    const size_t kstep = (size_t)(BK * 2);
    const size_t hstep = (size_t)HALF * K * 2;
    const size_t tstep = 2 * hstep;
    const unsigned ldsw = (unsigned)wid * 1024u;
    const int aoff = lds_byte(wr * 64 + fr, fq * 8), boff = lds_byte(wc * 32 + fr, fq * 8);
#define PG8_SA(b, h) (((b) * 2 + (h)) * HTB)
#define PG8_SB(b, h) ((4 + (b) * 2 + (h)) * HTB)
#define PG8_STAGE(bufoff, gbase, voff) do { _Pragma("unroll") for (int _i = 0; _i < 2; ++_i) \
        __builtin_amdgcn_global_load_lds((const unsigned*)((const char*)(gbase) + (voff)[_i]), (PG8_LAS unsigned*)(lds + (bufoff) + ldsw + _i * 8192), 16, 0, 0); } while (0)
#define PG8_LDA(dst, b, h) do { _Pragma("unroll") for (int m = 0; m < 4; ++m) _Pragma("unroll") for (int k = 0; k < 2; ++k) dst[m][k] = *(const PG8_LAS bf16x8*)(lds + PG8_SA(b, h) + aoff + m * 2048 + k * 1024); } while (0)
#define PG8_LDB(dst, b, h) do { _Pragma("unroll") for (int n = 0; n < 2; ++n) _Pragma("unroll") for (int k = 0; k < 2; ++k) dst[n][k] = *(const PG8_LAS bf16x8*)(lds + PG8_SB(b, h) + boff + n * 2048 + k * 1024); } while (0)
#define PG8_MMA(ai, bj, At, Bt) do { __builtin_amdgcn_s_setprio(1); _Pragma("unroll") for (int m = 0; m < 4; ++m) _Pragma("unroll") for (int n = 0; n < 2; ++n) _Pragma("unroll") for (int k = 0; k < 2; ++k) \
        acc[ai][bj][m][n] = __builtin_amdgcn_mfma_f32_16x16x32_f16(__builtin_bit_cast(pg8::hx8, Bt[n][k]), __builtin_bit_cast(pg8::hx8, At[m][k]), acc[ai][bj][m][n], 0, 0, 0); __builtin_amdgcn_s_setprio(0); } while (0)
#define PG8_WAIT_V(n) asm volatile("s_waitcnt vmcnt(" #n ")" ::: "memory")
#define PG8_WAIT_L(n) asm volatile("s_waitcnt lgkmcnt(" #n ")" ::: "memory")
#define PG8_BAR __builtin_amdgcn_s_barrier()
#define PG8_SCHED __builtin_amdgcn_sched_barrier(0)
    Unit cur, nxt; int ui = 0;
    if (!S.next(0, cur)) return;
    f32x4 acc[2][2][4][2];
#pragma unroll
    for (int a = 0; a < 2; ++a)
#pragma unroll
        for (int b = 0; b < 2; ++b)
#pragma unroll
            for (int m = 0; m < 4; ++m)
#pragma unroll
                for (int n = 0; n < 2; ++n) acc[a][b][m][n] = (f32x4){0.f, 0.f, 0.f, 0.f};
    bf16x8 At[4][2], B0[2][2], B1[2][2];
    const char* cA = (const char*)g.A + (size_t)cur.pm * tstep; const char* cB = (const char*)g.Bt + (size_t)cur.pn * tstep;
    S.a_ready(cur);
    if constexpr (SP2) {
        PG8_STAGE(PG8_SB(0, 0), cB, voffB); PG8_STAGE(PG8_SB(0, 1), cB + hstep, voffB); PG8_STAGE(PG8_SA(0, 0), cA, voffA); PG8_STAGE(PG8_SA(0, 1), cA + hstep, voffA);
        if (wr == 1) PG8_BAR;
        PG8_WAIT_V(2); PG8_BAR;
        PG8_STAGE(PG8_SB(1, 0), cB + kstep, voffB); PG8_STAGE(PG8_SA(1, 0), cA + kstep, voffA); PG8_STAGE(PG8_SB(1, 1), cB + hstep + kstep, voffB);
        PG8_WAIT_V(6); PG8_BAR;
    } else {
        PG8_STAGE(PG8_SB(0, 0), cB, voffB); PG8_STAGE(PG8_SA(0, 0), cA, voffA); PG8_STAGE(PG8_SB(0, 1), cB + hstep, voffB); PG8_STAGE(PG8_SA(0, 1), cA + hstep, voffA);
        if (wr == 1) PG8_BAR;
        PG8_WAIT_V(4); PG8_BAR;
        PG8_STAGE(PG8_SB(1, 0), cB + kstep, voffB); PG8_STAGE(PG8_SA(1, 0), cA + kstep, voffA); PG8_STAGE(PG8_SB(1, 1), cB + hstep + kstep, voffB);
        PG8_WAIT_V(6); PG8_BAR;
    }
    for (;;) {
        const bool has_next = S.next(ui + 1, nxt);
        const char* nA = has_next ? (const char*)g.A + (size_t)nxt.pm * tstep : cA; const char* nB = has_next ? (const char*)g.Bt + (size_t)nxt.pn * tstep : cB;
        for (int t = 0; t < nt; t += 2) {
            const bool last = (t == nt - 2);
            const char* a1 = cA + (size_t)(t + 1) * kstep;
            const char* a2 = last ? nA : cA + (size_t)(t + 2) * kstep; const char* b2 = last ? nB : cB + (size_t)(t + 2) * kstep;
            const char* a3 = a2 + kstep; const char* b3 = b2 + kstep;
            if (last && has_next) S.a_ready(nxt);
            if constexpr (SP2) {
            PG8_LDB(B0, 0, 0); PG8_LDB(B1, 0, 1); PG8_SCHED; PG8_LDA(At, 0, 0); PG8_STAGE(PG8_SA(1, 1), a1 + hstep, voffA);
            PG8_WAIT_V(8); PG8_WAIT_L(0); PG8_BAR; PG8_MMA(0, 0, At, B0); PG8_MMA(0, 1, At, B1); PG8_BAR; PG8_SCHED;
            PG8_LDA(At, 0, 1); PG8_STAGE(PG8_SB(0, 0), b2, voffB); PG8_STAGE(PG8_SB(0, 1), b2 + hstep, voffB); PG8_STAGE(PG8_SA(0, 0), a2, voffA);
            PG8_WAIT_V(8); PG8_WAIT_L(0); PG8_BAR; PG8_MMA(1, 0, At, B0); PG8_MMA(1, 1, At, B1); PG8_BAR; PG8_SCHED;
            PG8_LDB(B0, 1, 0); PG8_LDB(B1, 1, 1); PG8_SCHED; PG8_LDA(At, 1, 0); PG8_STAGE(PG8_SA(0, 1), a2 + hstep, voffA);
            PG8_WAIT_V(8); PG8_WAIT_L(0); PG8_BAR; PG8_MMA(0, 0, At, B0); PG8_MMA(0, 1, At, B1); PG8_BAR; PG8_SCHED;
            PG8_LDA(At, 1, 1); PG8_STAGE(PG8_SB(1, 0), b3, voffB); PG8_STAGE(PG8_SB(1, 1), b3 + hstep, voffB); PG8_STAGE(PG8_SA(1, 0), a3, voffA);
            PG8_WAIT_V(8); PG8_WAIT_L(0); PG8_BAR; PG8_MMA(1, 0, At, B0); PG8_MMA(1, 1, At, B1); PG8_BAR; PG8_SCHED;
            } else {
            PG8_LDB(B0, 0, 0); PG8_SCHED; PG8_LDA(At, 0, 0); PG8_STAGE(PG8_SA(1, 1), a1 + hstep, voffA);
            PG8_WAIT_L(8); PG8_BAR; PG8_WAIT_L(0); PG8_MMA(0, 0, At, B0); PG8_BAR; PG8_SCHED;
            PG8_LDB(B1, 0, 1); PG8_STAGE(PG8_SB(0, 0), b2, voffB);
            PG8_BAR; PG8_WAIT_L(0); PG8_MMA(0, 1, At, B1); PG8_BAR;
            PG8_LDA(At, 0, 1); PG8_STAGE(PG8_SA(0, 0), a2, voffA);
            PG8_BAR; PG8_WAIT_L(0); PG8_MMA(1, 0, At, B0); PG8_BAR; PG8_SCHED;
            PG8_STAGE(PG8_SB(0, 1), b2 + hstep, voffB);
            PG8_WAIT_V(6); PG8_BAR; PG8_MMA(1, 1, At, B1); PG8_BAR;
            PG8_LDB(B0, 1, 0); PG8_SCHED; PG8_LDA(At, 1, 0); PG8_STAGE(PG8_SA(0, 1), a2 + hstep, voffA);
            PG8_WAIT_L(8); PG8_BAR; PG8_WAIT_L(0); PG8_MMA(0, 0, At, B0); PG8_BAR; PG8_SCHED;
            PG8_LDB(B1, 1, 1); PG8_STAGE(PG8_SB(1, 0), b3, voffB);
            PG8_BAR; PG8_WAIT_L(0); PG8_MMA(0, 1, At, B1); PG8_BAR;
            PG8_LDA(At, 1, 1); PG8_STAGE(PG8_SA(1, 0), a3, voffA);
            PG8_BAR; PG8_WAIT_L(0); PG8_MMA(1, 0, At, B0); PG8_BAR; PG8_SCHED;
            PG8_STAGE(PG8_SB(1, 1), b3 + hstep, voffB);
            PG8_WAIT_V(6); PG8_BAR; PG8_MMA(1, 1, At, B1); PG8_BAR;
            }
        }
        if constexpr (ALIGN_EPI) { if (wr == 0) PG8_BAR; }
        if constexpr (!Epi::AFTER_DRAIN) { E(acc, cur, wr, wc, fr, fq); S.done(cur); }
        if (!has_next) break;
#pragma unroll
        for (int a = 0; a < 2; ++a)
#pragma unroll
            for (int b = 0; b < 2; ++b)
#pragma unroll
                for (int m = 0; m < 4; ++m)
#pragma unroll
                    for (int n = 0; n < 2; ++n) acc[a][b][m][n] = (f32x4){0.f, 0.f, 0.f, 0.f};
        cur = nxt; cA = nA; cB = nB; ++ui;
        if constexpr (ALIGN_EPI) { if (wr == 1) PG8_BAR; }
    }
    PG8_WAIT_V(0);
    if constexpr (!ALIGN_EPI) { if (wr == 0) PG8_BAR; }
    PG8_BAR;
    if constexpr (Epi::AFTER_DRAIN) { E.fused(acc, cur, wr, wc, fr, fq, lds, wid, lane); S.done(cur); }
#undef PG8_SA
#undef PG8_SB
#undef PG8_STAGE
#undef PG8_LDA
#undef PG8_LDB
#undef PG8_MMA
#undef PG8_WAIT_V
#undef PG8_WAIT_L
#undef PG8_BAR
#undef PG8_SCHED
}
}
#define LAS __attribute__((address_space(3)))
#define XB_TMO      128
#define XB_XCNT(j)  (256  + 64 * (j))
#define XB_XSUB(j)  (1280 + 64 * (j))
#define XB_XGEN(j)  (2304 + 64 * (j))
#define XB_TOP      3328
#define XB_TOPGEN   3392
#define XCD_BAR_WORDS 3456
#define XB_SPIN_CAP (1u << 18)

__device__ __forceinline__ unsigned xb_ld(unsigned* p)              { return __hip_atomic_load(p, __ATOMIC_RELAXED, __HIP_MEMORY_SCOPE_AGENT); }
__device__ __forceinline__ unsigned xb_add(unsigned* p, unsigned v) { return __hip_atomic_fetch_add(p, v, __ATOMIC_RELAXED, __HIP_MEMORY_SCOPE_AGENT); }
__device__ __forceinline__ unsigned xb_xcc_id() { return (unsigned)__builtin_amdgcn_s_getreg((3 << 11) | 20) & 0xFu; }
#define XB_SPIN(cond, bar) do { unsigned _sp = 0; while (cond) { __builtin_amdgcn_s_sleep(1); \
    if ((++_sp & 255u) == 0u) { if (xb_ld(&(bar)[XB_TMO])) break; if (_sp > XB_SPIN_CAP) { atomicAdd(&(bar)[XB_TMO], 1u); break; } } } } while (0)

struct XcdBarrier {
    unsigned* bar; unsigned x;
    volatile LAS unsigned* st;
};

__device__ __forceinline__ XcdBarrier xcd_barrier_post(unsigned* bar, volatile LAS unsigned* st) {
    XcdBarrier b; b.bar = bar; b.x = xb_xcc_id(); b.st = st;
    if (threadIdx.x == 0) (void)xb_add(&bar[XB_XCNT(b.x)], 1u);
    return b;
}
__device__ __forceinline__ void xcd_barrier_complete(unsigned* bar, unsigned x, unsigned& nloc, unsigned& nx) {
    const unsigned G = gridDim.x * gridDim.y * gridDim.z;
    unsigned sum, cnt, mine, sp = 0u;
    for (;;) {
        sum = 0u; cnt = 0u; mine = 0u;
#pragma unroll
        for (unsigned j = 0; j < 16; ++j) { const unsigned c = xb_ld(&bar[XB_XCNT(j)]); sum += c; cnt += (c > 0u) ? 1u : 0u; mine = (j == x) ? c : mine; }
        if (sum == G) break;
        __builtin_amdgcn_s_sleep(1);
        if ((++sp & 255u) == 0u) { if (xb_ld(&bar[XB_TMO])) break; if (sp > XB_SPIN_CAP) { atomicAdd(&bar[XB_TMO], 1u); break; } }
    }
    nloc = mine > 0u ? mine : 1u; nx = cnt > 0u ? cnt : 1u;
}

__device__ __forceinline__ void xcd_barrier(const XcdBarrier& b) {
    asm volatile("s_waitcnt vmcnt(0)" ::: "memory");
    __syncthreads();
    if (threadIdx.x == 0) {
        unsigned* bar = b.bar;
        __builtin_amdgcn_s_waitcnt(0);
        unsigned nloc = b.st[0], nx = b.st[1];
        if (nloc == 0u) { xcd_barrier_complete(bar, b.x, nloc, nx); b.st[0] = nloc; b.st[1] = nx; }
        const unsigned old = xb_add(&bar[XB_XSUB(b.x)], 1u);
        const unsigned gen = old / nloc;
        if (old + 1u == (gen + 1u) * nloc) {
            __builtin_amdgcn_fence(__ATOMIC_RELEASE, "agent");
            asm volatile("s_waitcnt vmcnt(0)" ::: "memory");
            const unsigned og = xb_add(&bar[XB_TOP], 1u);
            const unsigned tg = og / nx;
            if (og + 1u == (tg + 1u) * nx) xb_add(&bar[XB_TOPGEN], 1u);
            else XB_SPIN(xb_ld(&bar[XB_TOPGEN]) == tg, bar);
            __builtin_amdgcn_fence(__ATOMIC_ACQUIRE, "agent");
            xb_add(&bar[XB_XGEN(b.x)], 1u);
            asm volatile("s_waitcnt vmcnt(0)" ::: "memory");
        } else {
            XB_SPIN(xb_ld(&bar[XB_XGEN(b.x)]) == gen, bar);
            __builtin_amdgcn_fence(__ATOMIC_ACQUIRE, "agent");
            asm volatile("s_waitcnt vmcnt(0)" ::: "memory");
        }
    }
    __syncthreads();
}

namespace mk {
#define LAS __attribute__((address_space(3)))
#define GAS __attribute__((address_space(1)))
#define DI __device__ __forceinline__
typedef _Float16 f16;
typedef _Float16 hx8 __attribute__((ext_vector_type(8)));
typedef _Float16 hx4 __attribute__((ext_vector_type(4)));
typedef _Float16 hx2 __attribute__((ext_vector_type(2)));
typedef float f32x2 __attribute__((ext_vector_type(2)));
typedef float f32x4 __attribute__((ext_vector_type(4)));
typedef float f32x16 __attribute__((ext_vector_type(16)));
typedef unsigned u32x4 __attribute__((ext_vector_type(4)));
typedef unsigned u32x2 __attribute__((ext_vector_type(2)));
typedef unsigned long long u64;

constexpr int NB = 8, SEQ = 4096, DMODEL = 1024, NTOK = NB * SEQ;
constexpr int NWAVES = 8, NTHR = 512;
constexpr int NIN = 7768, N1 = 4352, N2 = 3584;
constexpr float EPS = 1e-6f;
constexpr float C2 = 0.125f * 1.4426950408889634f;
constexpr float KSCALE = 0.08838834764831845f;
constexpr int TOPK = 256;

constexpr size_t MiB = 1u << 20;
constexpr size_t WS_CTL = 0, CTL_ZERO_BYTES = 1 * MiB;
constexpr size_t WS_ROPE = 1 * MiB;
constexpr size_t WS_RSTD = 1 * MiB + 512 * 1024;
constexpr size_t WS_W1T = 2 * MiB;
constexpr size_t WS_W2T = 11 * MiB;
constexpr size_t WS_WAT = 18 * MiB, WS_WBT = 19 * MiB, WS_WOT = 20 * MiB;
constexpr size_t WS_KI = 22 * MiB;
constexpr size_t WS_WI = 26 * MiB;
constexpr size_t WS_LI = 28 * MiB, WS_LF = 28 * MiB + 512 * 1024;
constexpr size_t WS_BT = 29 * MiB;
constexpr size_t WS_CHS = 29 * MiB + 512 * 1024;
constexpr size_t WS_UN = 30 * MiB, WS_NV = 31 * MiB;
constexpr size_t WS_XH = 32 * MiB;
constexpr size_t WS_QA = 96 * MiB, WS_KA = 128 * MiB, WS_VA = 160 * MiB;
constexpr size_t WS_QI = 192 * MiB;
constexpr size_t WS_OA = 192 * MiB, WS_CELL = 224 * MiB;
constexpr size_t WS_BQ = 256 * MiB, WS_BK = 288 * MiB, WS_BV = 320 * MiB;
constexpr size_t WS_CST = 256 * MiB;
constexpr size_t WS_QC = 352 * MiB, WS_KC = 384 * MiB;
constexpr size_t WS_U = 416 * MiB;
constexpr size_t WS_MASK = 480 * MiB;
constexpr size_t WS_SZ = 96 * MiB, WS_AB = 128 * MiB;
constexpr size_t WS_SGA = 256 * MiB, WS_SGB = 320 * MiB;
constexpr size_t WS_T1 = 384 * MiB;
constexpr size_t WS_MRG = 32 * MiB;
constexpr size_t WS_PART = 26 * MiB;
constexpr size_t WS_END = 512 * MiB;

constexpr int LDS_BYTES = 147456;
constexpr int MISC_OFF = 131072 + 320;

DI unsigned pkh(float a, float b) { f32x2 v = {a, b}; return __builtin_bit_cast(unsigned, __builtin_convertvector(v, hx2)); }
DI hx8 pack8h(float a0, float a1, float a2, float a3, float a4, float a5, float a6, float a7) {
    u32x4 p = {pkh(a0, a1), pkh(a2, a3), pkh(a4, a5), pkh(a6, a7)}; return __builtin_bit_cast(hx8, p); }
DI f32x16 mfma32(hx8 a, hx8 b, f32x16 c) { return __builtin_amdgcn_mfma_f32_32x32x16_f16(a, b, c, 0, 0, 0); }
DI int crow(int i, int h) { return (i & 3) + 8 * (i >> 2) + 4 * h; }
DI float sigmoidf_(float x) { return 1.f / (1.f + __expf(-x)); }
DI float siluf_(float x) { return x / (1.f + __expf(-x)); }
DI float wave_sum(float v) {
#pragma unroll
    for (int o = 1; o < 64; o <<= 1) v += __shfl_xor(v, o);
    return v; }
DI float wave_max(float v) {
#pragma unroll
    for (int o = 1; o < 64; o <<= 1) v = fmaxf(v, __shfl_xor(v, o));
    return v; }
#define LDS_WAIT() asm volatile("s_waitcnt lgkmcnt(0)" ::: "memory")

__constant__ float ROPE_INV[8] = {1.0f, 0.1939227432012558f, 0.03760603070259094f, 0.007292664609849453f, 0.0014142135623842478f, 0.00027424818836152554f, 5.318296098266728e-05f, 1.0313386155758053e-05f};

struct ColMap1 { DI int operator()(int n) const {
    if (n < 1024) return n;
    if (n < 2048) return 2048 + (n - 1024);
    if (n < 2560) return 1024 + (n - 2048);
    if (n < 3072) return 3152 + (n - 2560);
    if (n < 3584) return 3664 + (n - 3072);
    if (n < 4096) return 4176 + (n - 3584);
    if (n < 4160) return 3072 + (n - 4096);
    if (n < 4176) return 3136 + (n - 4160);
    if (n < 4184) return 5712 + (n - 4176);
    return -1; } };
struct ColMap2 { DI int operator()(int n) const {
    if (n < 512) return 1536 + n;
    if (n < 1024) return 4688 + (n - 512);
    if (n < 1536) return 5200 + (n - 1024);
    if (n < 2560) return 5720 + (n - 1536);
    return 6744 + (n - 2560); } };
struct ColMapId { DI int operator()(int n) const { return n; } };

template <class CM>
DI void transpose_item(const float* __restrict__ W, int ldw, const float* __restrict__ gk, f16* WT, int K, LAS float* scr, int k0, int n0, int lane, CM cm) {
    const int sc = cm(n0 + (lane & 31));
#pragma unroll 8
    for (int i = 0; i < 32; ++i) { const int kk = 2 * i + (lane >> 5); float v = 0.f;
        if (sc >= 0) v = W[(size_t)(k0 + kk) * ldw + sc];
        if (gk) v *= gk[k0 + kk];
        scr[kk * 33 + (lane & 31)] = v; }
    LDS_WAIT();
    const int c = lane & 7;
#pragma unroll
    for (int j = 0; j < 4; ++j) { const int n = (lane >> 3) + 8 * j; const LAS float* s = scr + (8 * c) * 33 + n;
        u32x4 o; o.x = pkh(s[0 * 33], s[1 * 33]); o.y = pkh(s[2 * 33], s[3 * 33]); o.z = pkh(s[4 * 33], s[5 * 33]); o.w = pkh(s[6 * 33], s[7 * 33]);
        *(u32x4*)(WT + (size_t)(n0 + n) * K + k0 + 8 * c) = o; }
    LDS_WAIT();
}

struct In { const float *x, *norm_g, *w_in, *conv_w, *conv_b, *b_ig, *b_fg, *hn_g, *w_a, *w_b, *w_o, *fn_g; };

DI void p0_prologue(const In& in, unsigned char* ws, LAS unsigned char* lds, int gw, int NGW, int wave, int lane) {
    LAS float* scr = (LAS float*)(lds + wave * 16384);
    constexpr int I1 = 16 * (N1 / 32), I2 = 16 * (N2 / 32), IA = 8 * 32, IB = 8 * 32, IO = 16 * 32;
    constexpr int NITEMS = I1 + I2 + IA + IB + IO;
    for (int it = gw; it < NITEMS; it += NGW) {
        int r = it;
        if (r < I1) { const int nb = N1 / 32; transpose_item(in.w_in, NIN, in.norm_g, (f16*)(ws + WS_W1T), 1024, scr, 64 * (r / nb), 32 * (r % nb), lane, ColMap1()); continue; } r -= I1;
        if (r < I2) { const int nb = N2 / 32; transpose_item(in.w_in, NIN, in.norm_g, (f16*)(ws + WS_W2T), 1024, scr, 64 * (r / nb), 32 * (r % nb), lane, ColMap2()); continue; } r -= I2;
        if (r < IA) { transpose_item(in.w_a, 1024, nullptr, (f16*)(ws + WS_WAT), 512, scr, 64 * (r / 32), 32 * (r % 32), lane, ColMapId()); continue; } r -= IA;
        if (r < IB) { transpose_item(in.w_b, 1024, nullptr, (f16*)(ws + WS_WBT), 512, scr, 64 * (r / 32), 32 * (r % 32), lane, ColMapId()); continue; } r -= IB;
        transpose_item(in.w_o, 1024, nullptr, (f16*)(ws + WS_WOT), 1024, scr, 64 * (r / 32), 32 * (r % 32), lane, ColMapId());
    }
    f16* xh = (f16*)(ws + WS_XH); float* rstd = (float*)(ws + WS_RSTD);
    for (int m = gw; m < NTOK; m += NGW) {
        const f32x4* xr = (const f32x4*)(in.x + (size_t)m * DMODEL) + lane;
        f32x4 v[4]; float s = 0.f;
#pragma unroll
        for (int j = 0; j < 4; ++j) { v[j] = xr[64 * j]; s += (v[j].x * v[j].x + v[j].y * v[j].y) + (v[j].z * v[j].z + v[j].w * v[j].w); }
        s = wave_sum(s);
        if (lane == 0) rstd[m] = 1.0f / sqrtf(s * (1.f / DMODEL) + EPS);
        u32x2* o = (u32x2*)(xh + (size_t)m * DMODEL) + lane;
#pragma unroll
        for (int j = 0; j < 4; ++j) { u32x2 w; w.x = pkh(v[j].x, v[j].y); w.y = pkh(v[j].z, v[j].w); o[64 * j] = w; }
    }
    float* rope = (float*)(ws + WS_ROPE);
    for (int idx = gw * 64 + lane; idx < SEQ * 8; idx += NGW * 64) {
        const int pos = idx >> 3, j = idx & 7;
        const double rev = (double)pos * (double)ROPE_INV[j] * 0.15915494309189535;
        const float fr = (float)(rev - floor(rev));
        rope[pos * 16 + j] = __builtin_amdgcn_cosf(fr); rope[pos * 16 + 8 + j] = __builtin_amdgcn_sinf(fr);
    }
}

DI float logsigmoidf_(float x) { return fminf(x, 0.f) - log1pf(__expf(-fabsf(x))); }

struct EpiP1 {
    static constexpr bool PERM = true, AFTER_DRAIN = false;
    unsigned char* ws; const float* b_ig; const float* b_fg;
    DI void operator()(const f32x4 (&acc)[2][2][4][2], const pg8::Unit& u, int wr, int wc, int fr, int fq) const {
        const int pn = u.pn, row0 = u.pm * 256 + wr * 64 + fr;
        const float* rstd = (const float*)(ws + WS_RSTD); const float* rope = (const float*)(ws + WS_ROPE);
        if (pn < 16) {
            f16* base; int ld, colt; bool rope_tile = false; float sc = 1.f;
            if (pn < 2)       { base = (f16*)(ws + WS_QA); ld = 512;  colt = pn * 256;        rope_tile = true; sc = C2; }
            else if (pn < 4)  { base = (f16*)(ws + WS_KA); ld = 512;  colt = (pn - 2) * 256;  rope_tile = true; }
            else if (pn < 8)  { base = (f16*)(ws + WS_QI); ld = 1024; colt = (pn - 4) * 256;  rope_tile = true; }
            else if (pn < 10) { base = (f16*)(ws + WS_VA); ld = 512;  colt = (pn - 8) * 256; }
            else if (pn < 12) { base = (f16*)(ws + WS_BQ); ld = 512;  colt = (pn - 10) * 256; }
            else if (pn < 14) { base = (f16*)(ws + WS_BK); ld = 512;  colt = (pn - 12) * 256; }
            else              { base = (f16*)(ws + WS_BV); ld = 512;  colt = (pn - 14) * 256; }
            const bool do_rope = rope_tile && ((wc & 1) == 0);
            const float sgn = (fq == 0) ? -1.f : 1.f;
#pragma unroll
            for (int ai = 0; ai < 2; ++ai)
#pragma unroll
                for (int m = 0; m < 4; ++m) {
                    const int row = row0 + ai * 128 + m * 16; const float rs = rstd[row] * sc;
                    f32x4 cs0 = {}, cs1 = {}, sn0 = {}, sn1 = {};
                    if (do_rope) { const f32x4* rp = (const f32x4*)(rope + (size_t)(row & (SEQ - 1)) * 16); cs0 = rp[0]; cs1 = rp[1]; sn0 = rp[2]; sn1 = rp[3]; }
#pragma unroll
                    for (int bj = 0; bj < 2; ++bj) {
                        f32x4 v0 = acc[ai][bj][m][0] * rs, v1 = acc[ai][bj][m][1] * rs;
                        if (do_rope) {
                            f32x4 p0, p1;
#pragma unroll
                            for (int e = 0; e < 4; ++e) { p0[e] = __shfl_xor(v0[e], 16); p1[e] = __shfl_xor(v1[e], 16); }
                            if (fq < 2) { v0 = v0 * cs0 + (p0 * sn0) * sgn; v1 = v1 * cs1 + (p1 * sn1) * sgn; }
                        }
                        u32x4 w; w.x = pkh(v0[0], v0[1]); w.y = pkh(v0[2], v0[3]); w.z = pkh(v1[0], v1[1]); w.w = pkh(v1[2], v1[3]);
                        *(u32x4*)(base + (size_t)row * ld + colt + bj * 128 + wc * 32 + 8 * fq) = w;
                    }
                }
        } else {
            if (wc > 2) return;
            f16* ki = (f16*)(ws + WS_KI); float* wi = (float*)(ws + WS_WI); float* li = (float*)(ws + WS_LI); float* lf = (float*)(ws + WS_LF);
            const float sgn = (fq == 0) ? -1.f : 1.f;
#pragma unroll
            for (int ai = 0; ai < 2; ++ai)
#pragma unroll
                for (int m = 0; m < 4; ++m) {
                    const int row = row0 + ai * 128 + m * 16; const float rs = rstd[row];
                    f32x4 v0 = acc[ai][0][m][0] * rs, v1 = acc[ai][0][m][1] * rs;
                    if (wc < 2) {
                        if (wc == 0) {
                            const f32x4* rp = (const f32x4*)(rope + (size_t)(row & (SEQ - 1)) * 16); const f32x4 cs0 = rp[0], cs1 = rp[1], sn0 = rp[2], sn1 = rp[3];
                            f32x4 p0, p1;
#pragma unroll
                            for (int e = 0; e < 4; ++e) { p0[e] = __shfl_xor(v0[e], 16); p1[e] = __shfl_xor(v1[e], 16); }
                            if (fq < 2) { v0 = v0 * cs0 + (p0 * sn0) * sgn; v1 = v1 * cs1 + (p1 * sn1) * sgn; }
                        }
                        u32x4 w; w.x = pkh(v0[0], v0[1]); w.y = pkh(v0[2], v0[3]); w.z = pkh(v1[0], v1[1]); w.w = pkh(v1[2], v1[3]);
                        *(u32x4*)(ki + (size_t)row * 64 + wc * 32 + 8 * fq) = w;
                    } else {
                        if (fq < 2) { f32x4* o = (f32x4*)(wi + (size_t)row * 16 + 8 * fq); o[0] = v0 * (1.f / 32.f); o[1] = v1 * (1.f / 32.f); }
                        else if (fq == 2) {
                            const f32x4 bi = *(const f32x4*)b_ig, bf = *(const f32x4*)b_fg;
                            *(f32x4*)(li + (size_t)row * 4) = v0 + bi;
                            f32x4 t = v1 + bf; t[0] = logsigmoidf_(t[0]); t[1] = logsigmoidf_(t[1]); t[2] = logsigmoidf_(t[2]); t[3] = logsigmoidf_(t[3]);
                            *(f32x4*)(lf + (size_t)row * 4) = t;
                        }
                    }
                }
        }
    }
};

DI unsigned fkey(float f) { const unsigned u = __float_as_uint(f); return u ^ ((unsigned)((int)u >> 31) | 0x80000000u); }

template <int SHIFT, int NBITS, bool FIRST>
DI void radix_pass(const unsigned (&v)[64], int nreg, LAS unsigned* hist, int lane, unsigned& prefix, unsigned& rnk, unsigned& cnt_sel) {
    const u32x4 z = {0u, 0u, 0u, 0u};
#pragma unroll
    for (int q = 0; q < 8; ++q) *(LAS u32x4*)(hist + q * 256 + lane * 4) = z;
    LDS_WAIT();
#pragma unroll
    for (int i = 0; i < 64; ++i) if (i < nreg) {
        const unsigned k = v[i];
        const bool match = FIRST ? true : ((k >> (SHIFT + NBITS)) == prefix);
        if (match) atomicAdd((unsigned*)(hist + ((k >> SHIFT) & ((1u << NBITS) - 1u))), 1u);
    }
    LDS_WAIT();
    u32x4 hb[8]; unsigned tot = 0;
#pragma unroll
    for (int q = 0; q < 8; ++q) { hb[q] = *(const LAS u32x4*)(hist + lane * 32 + q * 4); tot += (hb[q].x + hb[q].y) + (hb[q].z + hb[q].w); }
    unsigned incl = tot;
#pragma unroll
    for (int o = 1; o < 64; o <<= 1) { const unsigned t = __shfl_down(incl, o); if (lane + o < 64) incl += t; }
    const unsigned above = incl - tot;
    const bool mine = (above < rnk) && (rnk <= above + tot);
    unsigned cum = above, dig = 0, rn = 0, cs = 0; bool found = false;
#pragma unroll
    for (int q = 7; q >= 0; --q)
#pragma unroll
        for (int e = 3; e >= 0; --e) { const unsigned c = hb[q][e];
            if (!found && cum + c >= rnk) { found = true; dig = (unsigned)(lane * 32 + q * 4 + e); rn = rnk - cum; cs = c; }
            cum += c; }
    const u64 bal = __ballot(mine);
    const int src = (int)__builtin_ctzll(bal | (1ull << 63));
    dig = __shfl(dig, src); rn = __shfl(rn, src); cs = __shfl(cs, src);
    prefix = FIRST ? dig : ((prefix << NBITS) | dig); rnk = rn; cnt_sel = cs;
    LDS_WAIT();
}

DI void p2_indexer_item(unsigned char* ws, LAS unsigned char* lds, int b, int c, int g, int wave, int lane) {
    const int t0 = b * SEQ + c * 64 + g * 8;
    u64* mask = (u64*)(ws + WS_MASK);
    const int ntw = 4 * (c >> 2) + 4;
    if (c < 4) {
        if (lane < 4) mask[(size_t)(t0 + wave) * 64 + lane] = (lane <= c) ? ~0ull : 0ull;
        return;
    }
    LAS float* sc = (LAS float*)lds;
    const int r = lane & 31, hf = lane >> 5, team = wave >> 1, par = wave & 1;
    {
        const f16* Qi = (const f16*)(ws + WS_QI); const f16* Ki = (const f16*)(ws + WS_KI); const float* Wi = (const float*)(ws + WS_WI);
        const int tq = t0 + 2 * team + ((r >> 2) & 1), head = (r & 3) + 4 * (r >> 3);
        hx8 af[4];
#pragma unroll
        for (int s = 0; s < 4; ++s) af[s] = *(const hx8*)(Qi + (size_t)tq * 1024 + head * 64 + 16 * s + 8 * hf);
        float wv[16];
        { const f32x4* wp = (const f32x4*)(Wi + (size_t)(t0 + 2 * team + hf) * 16);
#pragma unroll
          for (int q = 0; q < 4; ++q) { const f32x4 t = wp[q]; wv[4 * q] = t.x; wv[4 * q + 1] = t.y; wv[4 * q + 2] = t.z; wv[4 * q + 3] = t.w; } }
        const f16* kp = Ki + ((size_t)b * SEQ + r) * 64 + 8 * hf;
        const int nt32 = (c + 1) * 2;
        LAS float* scq = sc + (2 * team + hf) * 4096 + r;
#pragma unroll 2
        for (int j = par; j < nt32; j += 2) {
            hx8 bf[4];
#pragma unroll
            for (int s = 0; s < 4; ++s) bf[s] = *(const hx8*)(kp + (size_t)j * 2048 + 16 * s);
            f32x16 acc = {};
#pragma unroll
            for (int s = 0; s < 4; ++s) acc = mfma32(af[s], bf[s], acc);
            float sum = 0.f;
#pragma unroll
            for (int i = 0; i < 16; ++i) sum = fmaf(wv[i], fmaxf(acc[i], 0.f), sum);
            scq[32 * j] = sum;
        }
    }
    __syncthreads();
    {
        LAS float* arr = sc + wave * 4096; const int nreg = c + 1;
        unsigned v[64];
#pragma unroll
        for (int i = 0; i < 64; ++i) v[i] = (i < nreg) ? fkey(arr[64 * i + lane]) : 0u;
        LDS_WAIT();
        LAS unsigned* hist = (LAS unsigned*)arr;
        unsigned prefix = 0, rnk = TOPK, cs = 0;
        radix_pass<21, 11, true>(v, nreg, hist, lane, prefix, rnk, cs);
        radix_pass<10, 11, false>(v, nreg, hist, lane, prefix, rnk, cs);
        radix_pass<0, 10, false>(v, nreg, hist, lane, prefix, rnk, cs);
        const unsigned T = prefix;
        u64 myword = 0ull; unsigned cum_eq = 0;
#pragma unroll
        for (int i = 0; i < 64; ++i) if (i < ntw) {
            u64 word = 0ull;
            if (i < nreg) {
                const bool eq = (v[i] == T), gt = (v[i] > T);
                const u64 beq = __ballot(eq);
                const unsigned below = __builtin_amdgcn_mbcnt_hi((unsigned)(beq >> 32), __builtin_amdgcn_mbcnt_lo((unsigned)beq, 0u));
                const bool sel = gt || (eq && (cum_eq + below < rnk));
                cum_eq += (unsigned)__builtin_popcountll(beq);
                word = __ballot(sel);
            }
            if (lane == i) myword = word;
        }
        if (lane < ntw) mask[(size_t)(t0 + wave) * 64 + lane] = myword;
    }
    __syncthreads();
}

DI void p2_mlstm_local_item(const In& in, unsigned char* ws, LAS unsigned char* lds, int b, int h, int c, int tid) {
    const int lane = tid & 63, wave = tid >> 6;
    const int t0 = b * SEQ + c * 64, item = (b * 4 + h) * 64 + c;
    LAS f16* KT = (LAS f16*)lds;
    LAS f16* VT = (LAS f16*)(lds + 18432);
    LAS float* wk = (LAS float*)(lds + 36864);
    if (wave == 0) {
        const float* LI = (const float*)(ws + WS_LI); const float* LF = (const float*)(ws + WS_LF);
        const float li = LI[(size_t)(t0 + lane) * 4 + h], lf = LF[(size_t)(t0 + lane) * 4 + h];
        float bs = lf;
#pragma unroll
        for (int o = 1; o < 64; o <<= 1) { const float t = __shfl_up(bs, o); if (lane >= o) bs += t; }
        const float a = __shfl(bs, 63);
        const float gs = a - bs + li;
        const float mu = wave_max(gs);
        wk[lane] = __expf(gs - mu);
        ((float*)(ws + WS_BT))[(size_t)(t0 + lane) * 4 + h] = bs;
        if (lane == 0) { float* chs = (float*)(ws + WS_CHS); chs[item] = a; chs[2048 + item] = mu; }
    }
    __syncthreads();
    {
        const int d8 = (tid & 15) * 8, srow = tid >> 4;
        const f16* BQ = (const f16*)(ws + WS_BQ); const f16* BK = (const f16*)(ws + WS_BK); const f16* BV = (const f16*)(ws + WS_BV);
        f16* QC = (f16*)(ws + WS_QC); f16* KC = (f16*)(ws + WS_KC);
#pragma unroll
        for (int which = 0; which < 2; ++which) {
            const f16* src = which ? BK : BQ; f16* dst = which ? KC : QC;
            const int ch = which * 512 + h * 128 + d8;
            float w[4][8], bias[8];
#pragma unroll
            for (int j = 0; j < 4; ++j) { const f32x4 a0 = *(const f32x4*)(in.conv_w + j * 1024 + ch), a1 = *(const f32x4*)(in.conv_w + j * 1024 + ch + 4);
                w[j][0] = a0.x; w[j][1] = a0.y; w[j][2] = a0.z; w[j][3] = a0.w; w[j][4] = a1.x; w[j][5] = a1.y; w[j][6] = a1.z; w[j][7] = a1.w; }
            { const f32x4 a0 = *(const f32x4*)(in.conv_b + ch), a1 = *(const f32x4*)(in.conv_b + ch + 4);
              bias[0] = a0.x; bias[1] = a0.y; bias[2] = a0.z; bias[3] = a0.w; bias[4] = a1.x; bias[5] = a1.y; bias[6] = a1.z; bias[7] = a1.w; }
#pragma unroll
            for (int rr = 0; rr < 2; ++rr) {
                const int s = srow + 32 * rr; float o[8];
#pragma unroll
                for (int e = 0; e < 8; ++e) o[e] = bias[e];
#pragma unroll
                for (int j = 0; j < 4; ++j) { const int pos = c * 64 + s - 3 + j;
                    if (pos >= 0) { const hx8 x = *(const hx8*)(src + ((size_t)b * SEQ + pos) * 512 + h * 128 + d8);
#pragma unroll
                        for (int e = 0; e < 8; ++e) o[e] = fmaf(w[j][e], (float)x[e], o[e]); } }
                const float ks = which ? KSCALE : 1.f;
#pragma unroll
                for (int e = 0; e < 8; ++e) o[e] = siluf_(o[e]) * ks;
                *(hx8*)(dst + (size_t)(t0 + s) * 512 + h * 128 + d8) = pack8h(o[0], o[1], o[2], o[3], o[4], o[5], o[6], o[7]);
                if (which) { const float wks = wk[s];
#pragma unroll
                    for (int e = 0; e < 8; ++e) KT[(d8 + e) * 72 + s] = (f16)(o[e] * wks); }
            }
        }
#pragma unroll
        for (int rr = 0; rr < 2; ++rr) { const int s = srow + 32 * rr; const hx8 x = *(const hx8*)(BV + (size_t)(t0 + s) * 512 + h * 128 + d8);
#pragma unroll
            for (int e = 0; e < 8; ++e) VT[(d8 + e) * 72 + s] = x[e]; }
    }
    __syncthreads();
    {
        const int r = lane & 31, hf = lane >> 5, ti = wave >> 1;
        hx8 af[4];
#pragma unroll
        for (int ks = 0; ks < 4; ++ks) af[ks] = *(const LAS hx8*)(KT + (32 * ti + r) * 72 + 16 * ks + 8 * hf);
        f16* UT = (f16*)(ws + WS_U) + (size_t)item * 16384;
#pragma unroll
        for (int jj = 0; jj < 2; ++jj) { const int tj = (wave & 1) * 2 + jj; f32x16 acc = {};
#pragma unroll
            for (int ks = 0; ks < 4; ++ks) { const hx8 bf = *(const LAS hx8*)(VT + (32 * tj + r) * 72 + 16 * ks + 8 * hf); acc = mfma32(af[ks], bf, acc); }
#pragma unroll
            for (int g = 0; g < 4; ++g) { u32x2 w; w.x = pkh(acc[4 * g], acc[4 * g + 1]); w.y = pkh(acc[4 * g + 2], acc[4 * g + 3]);
                *(u32x2*)(UT + (size_t)(32 * tj + r) * 128 + 32 * ti + 8 * g + 4 * hf) = w; }
        }
        if (tid < 128) { float s = 0.f;
#pragma unroll 8
            for (int q = 0; q < 64; ++q) s += (float)KT[tid * 72 + q];
            ((float*)(ws + WS_UN))[(size_t)item * 128 + tid] = s; }
    }
    __syncthreads();
}

DI void p3_scan_task(unsigned char* ws, int wt, int lane) {
    const int bh = wt >> 6, sub = wt & 63;
    const float* chs = (const float*)(ws + WS_CHS); float* mc = (float*)(ws + WS_CHS) + 4096;
    const f16* U = (const f16*)(ws + WS_U) + (size_t)bh * 64 * 16384 + sub * 256 + lane * 4;
    f16* CS = (f16*)(ws + WS_CST) + (size_t)bh * 64 * 16384 + sub * 256 + lane * 4;
    const float* un = (const float*)(ws + WS_UN) + (size_t)bh * 64 * 128; float* nv = (float*)(ws + WS_NV) + (size_t)bh * 64 * 128;
    float C0 = 0.f, C1 = 0.f, C2_ = 0.f, C3 = 0.f, m = 0.f, nacc = 0.f;
    const bool do_n = (sub < 2);
#pragma unroll 4
    for (int c = 0; c < 64; ++c) {
        const float a = chs[bh * 64 + c], mu = chs[2048 + bh * 64 + c];
        const float mn = fmaxf(a + m, mu), al = __expf(a + m - mn), be = __expf(mu - mn);
        const hx4 u = *(const hx4*)(U + (size_t)c * 16384);
        u32x2 w; w.x = pkh(C0, C1); w.y = pkh(C2_, C3);
        *(u32x2*)(CS + (size_t)c * 16384) = w;
        if (do_n) { nv[c * 128 + sub * 64 + lane] = nacc; nacc = al * nacc + be * un[c * 128 + sub * 64 + lane]; }
        if (sub == 0 && lane == 0) mc[bh * 64 + c] = m;
        C0 = al * C0 + be * (float)u[0]; C1 = al * C1 + be * (float)u[1]; C2_ = al * C2_ + be * (float)u[2]; C3 = al * C3 + be * (float)u[3];
        m = mn;
    }
}

constexpr int AT_KS = 72;
constexpr int AT_KBYTES = 64 * AT_KS * 2;
DI void attn_unit(unsigned char* ws, LAS unsigned char* lds, int b, int hd, int qb, int tid) {
    const int lane = tid & 63, wave = tid >> 6, r = lane & 31, hf = lane >> 5;
    const f16* Qa = (const f16*)(ws + WS_QA); const f16* Ka = (const f16*)(ws + WS_KA); const f16* Va = (const f16*)(ws + WS_VA);
    const u64* mask = (const u64*)(ws + WS_MASK); f16* OA = (f16*)(ws + WS_OA);
    LAS float* wsf = (LAS float*)(lds + 4 * AT_KBYTES) + wave * 64;
    const int tqb = b * SEQ + qb * 256 + wave * 32;
    const int tq = tqb + r;
    hx8 qf[4];
#pragma unroll
    for (int s = 0; s < 4; ++s) qf[s] = *(const hx8*)(Qa + (size_t)tq * 512 + hd * 64 + 16 * s + 8 * hf);
    const int skv = tid >> 3, sd8 = (tid & 7) * 8;
    const f16* kg = Ka + ((size_t)b * SEQ + skv) * 512 + hd * 64 + sd8;
    const f16* vg = Va + ((size_t)b * SEQ + skv) * 512 + hd * 64 + sd8;
    const int NT = 4 * qb + 4;
    hx8 kreg = *(const hx8*)kg, vreg = *(const hx8*)vg;
    {
        LAS f16* Kt = (LAS f16*)lds; LAS f16* Vt = (LAS f16*)(lds + 2 * AT_KBYTES);
        *(LAS hx8*)(Kt + skv * AT_KS + sd8) = kreg;
#pragma unroll
        for (int e = 0; e < 8; ++e) Vt[(sd8 + e) * AT_KS + skv] = vreg[e];
    }
    __syncthreads();
    float m_run = -1e30f, l_run = 0.f;
    f32x16 o0 = {}, o1 = {};
    for (int t = 0; t < NT; ++t) {
        const int buf = t & 1;
        if (t + 1 < NT) { kreg = *(const hx8*)(kg + (size_t)(t + 1) * 64 * 512); vreg = *(const hx8*)(vg + (size_t)(t + 1) * 64 * 512); }
        const u64 mw = mask[(size_t)tq * 64 + t];
        const LAS f16* Kt = (const LAS f16*)(lds + buf * AT_KBYTES); const LAS f16* Vt = (const LAS f16*)(lds + (2 + buf) * AT_KBYTES);
        f32x16 p0 = {}, p1 = {};
#pragma unroll
        for (int s = 0; s < 4; ++s) {
            const hx8 k0 = *(const LAS hx8*)(Kt + r * AT_KS + 16 * s + 8 * hf);
            const hx8 k1 = *(const LAS hx8*)(Kt + (32 + r) * AT_KS + 16 * s + 8 * hf);
            p0 = mfma32(k0, qf[s], p0); p1 = mfma32(k1, qf[s], p1);
        }
        const unsigned lo = (unsigned)mw >> (4 * hf), hi = (unsigned)(mw >> 32) >> (4 * hf);
        float mx = -1e30f;
#pragma unroll
        for (int i = 0; i < 16; ++i) { const int bit = (i & 3) + 8 * (i >> 2);
            if ((lo >> bit) & 1u) mx = fmaxf(mx, p0[i]);
            if ((hi >> bit) & 1u) mx = fmaxf(mx, p1[i]); }
        mx = fmaxf(mx, __shfl_xor(mx, 32));
        const float m_new = fmaxf(m_run, mx);
        const float alpha = __builtin_amdgcn_exp2f(m_run - m_new);
        m_run = m_new;
        float ls = 0.f;
#pragma unroll
        for (int i = 0; i < 16; ++i) { const int bit = (i & 3) + 8 * (i >> 2);
            const float e0 = __builtin_amdgcn_exp2f(p0[i] - m_new), e1 = __builtin_amdgcn_exp2f(p1[i] - m_new);
            p0[i] = ((lo >> bit) & 1u) ? e0 : 0.f; p1[i] = ((hi >> bit) & 1u) ? e1 : 0.f;
            ls += p0[i] + p1[i]; }
        l_run = l_run * alpha + ls;
        if (!__all(alpha == 1.f)) {
            if (hf == 0) wsf[r] = alpha;
            LDS_WAIT();
#pragma unroll
            for (int i = 0; i < 16; ++i) { const float a = wsf[crow(i, hf)]; o0[i] *= a; o1[i] *= a; }
            LDS_WAIT();
        }
#pragma unroll
        for (int tau = 0; tau < 2; ++tau)
#pragma unroll
            for (int s2 = 0; s2 < 2; ++s2) {
                const f32x16& p = tau ? p1 : p0;
                const hx8 pa = pack8h(p[8 * s2], p[8 * s2 + 1], p[8 * s2 + 2], p[8 * s2 + 3], p[8 * s2 + 4], p[8 * s2 + 5], p[8 * s2 + 6], p[8 * s2 + 7]);
#pragma unroll
                for (int db = 0; db < 2; ++db) {
                    const LAS f16* vp = Vt + (32 * db + r) * AT_KS + 32 * tau + 16 * s2 + 4 * hf;
                    const hx4 vlo = *(const LAS hx4*)vp, vhi = *(const LAS hx4*)(vp + 8);
                    const hx8 vb = __builtin_shufflevector(vlo, vhi, 0, 1, 2, 3, 4, 5, 6, 7);
                    if (db == 0) o0 = mfma32(pa, vb, o0); else o1 = mfma32(pa, vb, o1);
                }
            }
        if (t + 1 < NT) {
            LAS f16* Kn = (LAS f16*)(lds + (buf ^ 1) * AT_KBYTES); LAS f16* Vn = (LAS f16*)(lds + (2 + (buf ^ 1)) * AT_KBYTES);
            *(LAS hx8*)(Kn + skv * AT_KS + sd8) = kreg;
#pragma unroll
            for (int e = 0; e < 8; ++e) Vn[(sd8 + e) * AT_KS + skv] = vreg[e];
        }
        __syncthreads();
    }
    const float lt = l_run + __shfl_xor(l_run, 32);
    if (hf == 0) wsf[32 + r] = 1.f / lt;
    LDS_WAIT();
#pragma unroll
    for (int i = 0; i < 16; ++i) { const int q = crow(i, hf); const float rl = wsf[32 + q];
        f16* op = OA + (size_t)(tqb + q) * 512 + hd * 64 + r;
        op[0] = (f16)(o0[i] * rl); op[32] = (f16)(o1[i] * rl); }
    __syncthreads();
}

DI void p4_mlstm_out_item(unsigned char* ws, LAS unsigned char* lds, int b, int h, int c, int tid) {
    const int lane = tid & 63, wave = tid >> 6, r = lane & 31, hf = lane >> 5;
    const int t0 = b * SEQ + c * 64, item = (b * 4 + h) * 64 + c;
    LAS f16* VT = (LAS f16*)lds;
    LAS float* vsl = (LAS float*)(lds + 18432);
    LAS float* pmx = vsl + 64;
    LAS float* btl = vsl + 128;
    LAS float* nl = vsl + 192;
    LAS float* wsc = vsl + 320 + wave * 64;
    const f16* QC = (const f16*)(ws + WS_QC); const f16* KC = (const f16*)(ws + WS_KC); const f16* BV = (const f16*)(ws + WS_BV);
    const f16* CS = (const f16*)(ws + WS_CST) + (size_t)item * 16384;
    if (wave == 0) {
        const float li = ((const float*)(ws + WS_LI))[(size_t)(t0 + lane) * 4 + h], bt = ((const float*)(ws + WS_BT))[(size_t)(t0 + lane) * 4 + h];
        const float vs = li - bt; float pm = vs;
#pragma unroll
        for (int o = 1; o < 64; o <<= 1) { const float t = __shfl_up(pm, o); if (lane >= o) pm = fmaxf(pm, t); }
        vsl[lane] = vs; pmx[lane] = pm; btl[lane] = bt;
    } else if (wave < 3) { const int d = (wave - 1) * 64 + lane; nl[d] = ((const float*)(ws + WS_NV))[(size_t)item * 128 + d]; }
    { const int d8 = (tid & 15) * 8, srow = tid >> 4;
#pragma unroll
      for (int rr = 0; rr < 2; ++rr) { const int s = srow + 32 * rr; const hx8 x = *(const hx8*)(BV + (size_t)(t0 + s) * 512 + h * 128 + d8);
#pragma unroll
          for (int e = 0; e < 8; ++e) VT[(d8 + e) * 72 + s] = x[e]; } }
    const float m_c = ((const float*)(ws + WS_CHS))[4096 + item];
    const int ti = wave & 1, eb = wave >> 1;
    hx8 qf[8];
#pragma unroll
    for (int ks = 0; ks < 8; ++ks) qf[ks] = *(const hx8*)(QC + (size_t)(t0 + 32 * ti + r) * 512 + h * 128 + 16 * ks + 8 * hf);
    f32x16 st0 = {}, st1 = {}, gacc = {};
#pragma unroll
    for (int ks = 0; ks < 8; ++ks) {
        const hx8 k0 = *(const hx8*)(KC + (size_t)(t0 + r) * 512 + h * 128 + 16 * ks + 8 * hf);
        const hx8 k1 = *(const hx8*)(KC + (size_t)(t0 + 32 + r) * 512 + h * 128 + 16 * ks + 8 * hf);
        st0 = mfma32(k0, qf[ks], st0); st1 = mfma32(k1, qf[ks], st1);
        const hx8 cb = *(const hx8*)(CS + (size_t)(32 * eb + r) * 128 + 16 * ks + 8 * hf);
        gacc = mfma32(qf[ks], cb, gacc);
    }
    __syncthreads();
    const int t = 32 * ti + r;
    const float Mt = fmaxf(m_c, pmx[t]), bt = btl[t];
    const float w_inter = __expf(m_c - Mt), m_t = bt + Mt;
    float qn = 0.f;
#pragma unroll
    for (int ks = 0; ks < 8; ++ks)
#pragma unroll
        for (int j = 0; j < 8; ++j) qn = fmaf((float)qf[ks][j], nl[16 * ks + 8 * hf + j], qn);
    qn += __shfl_xor(qn, 32);
    float rs = 0.f;
#pragma unroll
    for (int i = 0; i < 16; ++i) { const int s0 = crow(i, hf), s1 = 32 + s0;
        const float e0 = (s0 <= t) ? __expf(vsl[s0] - Mt) : 0.f, e1 = (s1 <= t) ? __expf(vsl[s1] - Mt) : 0.f;
        st0[i] *= e0; st1[i] *= e1; rs += st0[i] + st1[i]; }
    rs += __shfl_xor(rs, 32);
    const float den = w_inter * qn + rs;
    const float dn = fmaxf(fabsf(den), __expf(-m_t));
    if (hf == 0) { wsc[r] = w_inter; wsc[32 + r] = 1.f / dn; }
    LDS_WAIT();
    f32x16 hacc = {};
#pragma unroll
    for (int i = 0; i < 16; ++i) hacc[i] = gacc[i] * wsc[crow(i, hf)];
#pragma unroll
    for (int tau = 0; tau < 2; ++tau)
#pragma unroll
        for (int s2 = 0; s2 < 2; ++s2) {
            const f32x16& p = tau ? st1 : st0;
            const hx8 pa = pack8h(p[8 * s2], p[8 * s2 + 1], p[8 * s2 + 2], p[8 * s2 + 3], p[8 * s2 + 4], p[8 * s2 + 5], p[8 * s2 + 6], p[8 * s2 + 7]);
            const LAS f16* vp = VT + (32 * eb + r) * 72 + 32 * tau + 16 * s2 + 4 * hf;
            const hx4 vlo = *(const LAS hx4*)vp, vhi = *(const LAS hx4*)(vp + 8);
            hacc = mfma32(pa, __builtin_shufflevector(vlo, vhi, 0, 1, 2, 3, 4, 5, 6, 7), hacc);
        }
    f16* CELL = (f16*)(ws + WS_CELL);
#pragma unroll
    for (int i = 0; i < 16; ++i) { const int tt = crow(i, hf);
        CELL[(size_t)(t0 + 32 * ti + tt) * 512 + h * 128 + 32 * eb + r] = (f16)(hacc[i] * wsc[32 + tt]); }
    __syncthreads();
}

struct EpiP5a {
    static constexpr bool PERM = true, AFTER_DRAIN = false;
    unsigned char* ws;
    DI void operator()(const f32x4 (&acc)[2][2][4][2], const pg8::Unit& u, int wr, int wc, int fr, int fq) const {
        const int pn = u.pn, row0 = u.pm * 256 + wr * 64 + fr; const float* rstd = (const float*)(ws + WS_RSTD);
        f16* base; int ld, colt, mode;
        if (pn < 2)       { base = (f16*)(ws + WS_OA);   ld = 512;  colt = pn * 256;        mode = 0; }
        else if (pn < 4)  { base = (f16*)(ws + WS_SZ);   ld = 512;  colt = (pn - 2) * 256;  mode = 1; }
        else if (pn < 6)  { base = (f16*)(ws + WS_CELL); ld = 512;  colt = (pn - 4) * 256;  mode = 2; }
        else if (pn < 10) { base = (f16*)(ws + WS_SGA);  ld = 1024; colt = (pn - 6) * 256;  mode = 3; }
        else              { base = (f16*)(ws + WS_SGB);  ld = 1024; colt = (pn - 10) * 256; mode = 3; }
#pragma unroll
        for (int ai = 0; ai < 2; ++ai)
#pragma unroll
            for (int m = 0; m < 4; ++m) { const int row = row0 + ai * 128 + m * 16; const float rs = rstd[row];
#pragma unroll
                for (int bj = 0; bj < 2; ++bj) {
                    f16* p = base + (size_t)row * ld + colt + bj * 128 + wc * 32 + 8 * fq;
                    float z[8];
#pragma unroll
                    for (int e = 0; e < 4; ++e) { z[e] = acc[ai][bj][m][0][e] * rs; z[4 + e] = acc[ai][bj][m][1][e] * rs; }
                    if (mode == 0 || mode == 2) { const hx8 in = *(const hx8*)p;
#pragma unroll
                        for (int e = 0; e < 8; ++e) z[e] = (float)in[e] * (mode == 0 ? siluf_(z[e]) : sigmoidf_(z[e])); }
                    else {
#pragma unroll
                        for (int e = 0; e < 8; ++e) z[e] = (mode == 1) ? siluf_(z[e]) : sigmoidf_(z[e]); }
                    *(hx8*)p = pack8h(z[0], z[1], z[2], z[3], z[4], z[5], z[6], z[7]);
                } }
    }
};
DI void p5b_headnorm_row(const float* hn_g, unsigned char* ws, int t, int lane) {
    const hx8 e = *((const hx8*)((const f16*)(ws + WS_CELL) + (size_t)t * 512) + lane);
    const hx8 z = *((const hx8*)((const f16*)(ws + WS_SZ) + (size_t)t * 512) + lane);
    float x[8], s = 0.f;
#pragma unroll
    for (int i = 0; i < 8; ++i) { x[i] = (float)e[i]; s += x[i]; }
#pragma unroll
    for (int o = 1; o < 16; o <<= 1) s += __shfl_xor(s, o);
    const float mu = s * (1.f / 128.f); float q = 0.f;
#pragma unroll
    for (int i = 0; i < 8; ++i) { x[i] -= mu; q += x[i] * x[i]; }
#pragma unroll
    for (int o = 1; o < 16; o <<= 1) q += __shfl_xor(q, o);
    const float rs = 1.0f / sqrtf(q * (1.f / 128.f) + EPS);
    const f32x4 g0 = *((const f32x4*)hn_g + 2 * lane), g1 = *((const f32x4*)hn_g + 2 * lane + 1);
    const float g[8] = {g0.x, g0.y, g0.z, g0.w, g1.x, g1.y, g1.z, g1.w};
    float y[8];
#pragma unroll
    for (int i = 0; i < 8; ++i) y[i] = x[i] * rs * g[i] * (float)z[i];
    *((hx8*)((f16*)(ws + WS_AB) + (size_t)t * 512) + lane) = pack8h(y[0], y[1], y[2], y[3], y[4], y[5], y[6], y[7]);
}
template <int PASS> struct EpiP5c {
    static constexpr bool PERM = true, AFTER_DRAIN = false;
    unsigned char* ws;
    DI void operator()(const f32x4 (&acc)[2][2][4][2], const pg8::Unit& u, int wr, int wc, int fr, int fq) const {
        const int row0 = u.pm * 256 + wr * 64 + fr, col0 = u.pn * 256 + wc * 32 + 8 * fq;
        const f16* sg = (const f16*)(ws + (PASS == 1 ? WS_SGA : WS_SGB)); float* t1 = (float*)(ws + WS_T1); f16* mrg = (f16*)(ws + WS_MRG);
#pragma unroll
        for (int ai = 0; ai < 2; ++ai)
#pragma unroll
            for (int m = 0; m < 4; ++m) { const int row = row0 + ai * 128 + m * 16;
#pragma unroll
                for (int bj = 0; bj < 2; ++bj) { const size_t off = (size_t)row * 1024 + col0 + bj * 128;
                    const hx8 gt = *(const hx8*)(sg + off);
                    f32x4 v0 = acc[ai][bj][m][0], v1 = acc[ai][bj][m][1];
#pragma unroll
                    for (int e = 0; e < 4; ++e) { v0[e] *= (float)gt[e]; v1[e] *= (float)gt[4 + e]; }
                    if (PASS == 1) { *(f32x4*)(t1 + off) = v0; *(f32x4*)(t1 + off + 4) = v1; }
                    else { v0 += *(const f32x4*)(t1 + off); v1 += *(const f32x4*)(t1 + off + 4);
                        *(hx8*)(mrg + off) = pack8h(v0[0], v0[1], v0[2], v0[3], v1[0], v1[1], v1[2], v1[3]); }
                } }
    }
};
struct EpiP5d {
    static constexpr bool PERM = true, AFTER_DRAIN = false;
    const float* x; float* out; unsigned char* ws;
    DI void operator()(const f32x4 (&acc)[2][2][4][2], const pg8::Unit& u, int wr, int wc, int fr, int fq) const {
        const int row0 = u.pm * 256 + wr * 64 + fr, col0 = u.pn * 256 + wc * 32 + 8 * fq; float* part = (float*)(ws + WS_PART);
#pragma unroll
        for (int ai = 0; ai < 2; ++ai)
#pragma unroll
            for (int m = 0; m < 4; ++m) { const int row = row0 + ai * 128 + m * 16; float ss = 0.f;
#pragma unroll
                for (int bj = 0; bj < 2; ++bj) { const size_t off = (size_t)row * 1024 + col0 + bj * 128;
                    const f32x4 y0 = acc[ai][bj][m][0] + *(const f32x4*)(x + off), y1 = acc[ai][bj][m][1] + *(const f32x4*)(x + off + 4);
                    *(f32x4*)(out + off) = y0; *(f32x4*)(out + off + 4) = y1;
                    ss += (y0.x * y0.x + y0.y * y0.y) + (y0.z * y0.z + y0.w * y0.w) + (y1.x * y1.x + y1.y * y1.y) + (y1.z * y1.z + y1.w * y1.w); }
                ss += __shfl_xor(ss, 16); ss += __shfl_xor(ss, 32);
                if (fq == 0) part[(size_t)row * 16 + u.pn * 4 + wc] = ss; }
    }
};
DI void p5e_norm_row(const float* fn_g, float* out, unsigned char* ws, int t, int lane) {
    const float* part = (const float*)(ws + WS_PART) + (size_t)t * 16;
    const f32x4 a = *(const f32x4*)part, b2 = *(const f32x4*)(part + 4), c = *(const f32x4*)(part + 8), d = *(const f32x4*)(part + 12);
    const float ss = ((a.x + a.y) + (a.z + a.w)) + ((b2.x + b2.y) + (b2.z + b2.w)) + ((c.x + c.y) + (c.z + c.w)) + ((d.x + d.y) + (d.z + d.w));
    const float rs = 1.0f / sqrtf(ss * (1.f / DMODEL) + EPS);
    f32x4* o = (f32x4*)(out + (size_t)t * DMODEL) + lane; const f32x4* g = (const f32x4*)fn_g + lane;
#pragma unroll
    for (int j = 0; j < 4; ++j) { f32x4 v = o[64 * j]; const f32x4 gg = g[64 * j]; v = v * rs * gg; o[64 * j] = v; }
}

#ifndef MK_N_LAUNCHES
#define MK_N_LAUNCHES 10
#endif
constexpr int NPHASE = 10;
constexpr int CW_BAR = 4096;

struct Args { const float* in[12]; float* out; unsigned char* ws; int ph_lo, ph_hi; };

__global__ void __launch_bounds__(NTHR, 2) mk_fwd(Args args) {
    extern __shared__ __attribute__((aligned(16))) unsigned char lds_raw[];
    LAS unsigned char* lds = (LAS unsigned char*)lds_raw;
    const int tid = threadIdx.x, lane = tid & 63, wave = __builtin_amdgcn_readfirstlane(tid >> 6);
    const int G = gridDim.x, bx = blockIdx.x;
    const int vcu = (G % 8 == 0) ? (bx % 8) * (G / 8) + bx / 8 : bx;
    const int gw = vcu * NWAVES + wave, NGW = G * NWAVES;
    unsigned char* ws = args.ws;
    In in; in.x = args.in[0]; in.norm_g = args.in[1]; in.w_in = args.in[2]; in.conv_w = args.in[3]; in.conv_b = args.in[4]; in.b_ig = args.in[5]; in.b_fg = args.in[6];
    in.hn_g = args.in[7]; in.w_a = args.in[8]; in.w_b = args.in[9]; in.w_o = args.in[10]; in.fn_g = args.in[11];
    volatile LAS unsigned* MISC = (volatile LAS unsigned*)(lds + MISC_OFF);
    for (int u = tid; u < (LDS_BYTES - 131072) / 4; u += NTHR) ((LAS unsigned*)(lds + 131072))[u] = 0u;
    __syncthreads();
    const int lo = args.ph_lo, hi = args.ph_hi;
    const bool multi = (hi - lo) > 1;
    XcdBarrier bar; bar.bar = (unsigned*)(ws + WS_CTL) + CW_BAR; bar.x = 0; bar.st = nullptr;
    if (multi) bar = xcd_barrier_post((unsigned*)(ws + WS_CTL) + CW_BAR, MISC + 8);
#define IN_(k) (lo <= (k) && (k) < hi)
#define SEAM(k) do { if (IN_(k) && IN_((k) + 1)) xcd_barrier(bar); } while (0)

    if (IN_(0)) { p0_prologue(in, ws, lds, gw, NGW, wave, lane); }
    SEAM(0);
    if (IN_(1)) {
        pg8::Gemm g{(const pg8::bf16_t*)(ws + WS_XH), (const pg8::bf16_t*)(ws + WS_W1T), NTOK, N1, DMODEL}; pg8::StaticOrder S; S.init(NTOK, N1, G, bx);
        EpiP1 E{ws, in.b_ig, in.b_fg};
        pg8::gemm_phase<EpiP1, pg8::StaticOrder, true, true>(lds, g, S, E);
    }
    SEAM(1);
    if (IN_(2)) {
        if (G == 256) {
            const int q = vcu & 63, rr = vcu >> 6;
            for (int i = 0; i < 16; ++i) { const int c = (i & 1) ? 63 - (8 * rr + (i >> 1)) : 8 * rr + (i >> 1); p2_indexer_item(ws, lds, q >> 3, c, q & 7, wave, lane); }
        } else {
            for (int it = vcu; it < 4096; it += G) p2_indexer_item(ws, lds, (it >> 3) & 7, it >> 6, it & 7, wave, lane);
        }
        for (int it = vcu; it < 2048; it += G) p2_mlstm_local_item(in, ws, lds, it >> 8, (it >> 6) & 3, it & 63, tid);
    }
    SEAM(2);
    if (IN_(3)) {
        for (int wt = gw; wt < 2048; wt += NGW) p3_scan_task(ws, wt, lane);
        if (G == 256) {
            const int bh = vcu >> 2, s = vcu & 3;
            for (int i = 0; i < 4; ++i) { const int qb = (i == 0) ? s : (i == 1) ? 7 - s : (i == 2) ? 8 + s : 15 - s; attn_unit(ws, lds, bh >> 3, bh & 7, qb, tid); }
        } else {
            for (int it = vcu; it < 1024; it += G) attn_unit(ws, lds, it >> 7, (it >> 4) & 7, it & 15, tid);
        }
    }
    SEAM(3);
    if (IN_(4)) {
        for (int it = vcu; it < 2048; it += G) p4_mlstm_out_item(ws, lds, it >> 8, (it >> 6) & 3, it & 63, tid);
    }
    SEAM(4);
    if (IN_(5)) {
        pg8::Gemm g{(const pg8::bf16_t*)(ws + WS_XH), (const pg8::bf16_t*)(ws + WS_W2T), NTOK, N2, DMODEL}; pg8::StaticOrder S; S.init(NTOK, N2, G, bx);
        EpiP5a E{ws};
        pg8::gemm_phase<EpiP5a, pg8::StaticOrder, true, true>(lds, g, S, E);
    }
    SEAM(5);
    if (IN_(6)) { for (int t = gw; t < NTOK; t += NGW) p5b_headnorm_row(in.hn_g, ws, t, lane); }
    SEAM(6);
    if (IN_(7)) {
        { pg8::Gemm g{(const pg8::bf16_t*)(ws + WS_OA), (const pg8::bf16_t*)(ws + WS_WAT), NTOK, DMODEL, 512}; pg8::StaticOrder S; S.init(NTOK, DMODEL, G, bx);
          EpiP5c<1> E{ws}; pg8::gemm_phase<EpiP5c<1>, pg8::StaticOrder, true, true>(lds, g, S, E); }
        { pg8::Gemm g{(const pg8::bf16_t*)(ws + WS_AB), (const pg8::bf16_t*)(ws + WS_WBT), NTOK, DMODEL, 512}; pg8::StaticOrder S; S.init(NTOK, DMODEL, G, bx);
          EpiP5c<2> E{ws}; pg8::gemm_phase<EpiP5c<2>, pg8::StaticOrder, true, true>(lds, g, S, E); }
    }
    SEAM(7);
    if (IN_(8)) {
        pg8::Gemm g{(const pg8::bf16_t*)(ws + WS_MRG), (const pg8::bf16_t*)(ws + WS_WOT), NTOK, DMODEL, DMODEL}; pg8::StaticOrder S; S.init(NTOK, DMODEL, G, bx);
        EpiP5d E{in.x, args.out, ws};
        pg8::gemm_phase<EpiP5d, pg8::StaticOrder, true, true>(lds, g, S, E);
    }
    SEAM(8);
    if (IN_(9)) { for (int t = gw; t < NTOK; t += NGW) p5e_norm_row(in.fn_g, args.out, ws, t, lane); }
#undef IN_
#undef SEAM
}
}

extern "C" void kernel_launch(void* const* d_in, const int* in_sizes, int n_in, void* d_out, int out_size, void* d_ws, size_t ws_size, hipStream_t stream) {
    using namespace mk;
    static int grid = 0;
    if (grid == 0) {
        if (n_in != 12 || out_size != NTOK * DMODEL || ws_size < WS_END) { fprintf(stderr, "kernel_launch: unexpected shapes (n_in %d, out %d, ws %zu)\n", n_in, out_size, ws_size); grid = -1; return; }
        int dev = 0, cus = 0, per_cu = 0;
        if (hipGetDevice(&dev) != hipSuccess || hipDeviceGetAttribute(&cus, hipDeviceAttributeMultiprocessorCount, dev) != hipSuccess) { grid = -1; return; }
        if (hipFuncSetAttribute((const void*)mk_fwd, hipFuncAttributeMaxDynamicSharedMemorySize, LDS_BYTES) != hipSuccess) { fprintf(stderr, "kernel_launch: hipFuncSetAttribute failed\n"); grid = -1; return; }
        if (hipOccupancyMaxActiveBlocksPerMultiprocessor(&per_cu, (const void*)mk_fwd, NTHR, LDS_BYTES) != hipSuccess || per_cu < 1) { fprintf(stderr, "kernel_launch: occupancy query says %d\n", per_cu); per_cu = 1; }
        (void)hipGetLastError();
        grid = cus;
    }
    if (grid < 0) return;
    (void)hipMemsetAsync((char*)d_ws + WS_CTL, 0, CTL_ZERO_BYTES, stream);
    Args a{};
    for (int i = 0; i < 12; ++i) a.in[i] = (const float*)d_in[i];
    a.out = (float*)d_out; a.ws = (unsigned char*)d_ws;
#if MK_N_LAUNCHES == 1
    a.ph_lo = 0; a.ph_hi = NPHASE;
    void* kargs[] = {&a};
    hipError_t e = hipLaunchCooperativeKernel((const void*)mk_fwd, dim3(grid), dim3(NTHR), kargs, LDS_BYTES, stream);
    if (e != hipSuccess) fprintf(stderr, "kernel_launch: cooperative launch failed: %s (grid %d)\n", hipGetErrorString(e), grid);
#else
    for (int p = 0; p < NPHASE; ++p) { a.ph_lo = p; a.ph_hi = p + 1; hipLaunchKernelGGL(mk_fwd, dim3(grid), dim3(NTHR), LDS_BYTES, stream, a); }
#endif
}
```
